# Optimizing an MI355X kernel written in HIP

```python
import math
import jax, jax.numpy as jnp
from jax import lax
import numpy as np

D_MODEL = 2048
BATCH = 2
SEQ = 8192
DEPTH = 1
DEC_BATCH = 16
DEC_SEQ = 64
PAST_LEN = 2048

CHUNK = 64
HEAD_DIM = 64
CONV_WIDTH = D_MODEL // 2
CONV_K = 3
N_HEADS = (D_MODEL - CONV_WIDTH) // HEAD_DIM
N_KV_HEADS = 4
GROUP = N_HEADS // N_KV_HEADS
ATTN_WIDTH = N_HEADS * HEAD_DIM
KV_WIDTH = N_KV_HEADS * HEAD_DIM
MIX_WIDTH = CONV_WIDTH + ATTN_WIDTH
IN_COLS = 3 * CONV_WIDTH + ATTN_WIDTH + 2 * KV_WIDTH
WINDOW = 128
WINDOW_CHUNKS = WINDOW // CHUNK
BAND = (WINDOW_CHUNKS + 1) * CHUNK
NUM_BUCKETS = 32
MAX_DISTANCE = 128
D_FF = -(-8 * D_MODEL // (3 * 256)) * 256
EPS = 1e-6
NEG = -1e30

kernel_name = "hybrid_conv_swa_streaming_step"


def rmsnorm(x, g):
    xf = x.astype(jnp.float32)
    y = xf * lax.rsqrt(jnp.mean(xf * xf, axis=-1, keepdims=True) + EPS) * g.astype(jnp.float32)
    return y.astype(x.dtype)


def t5_bucket(rel):
    half = NUM_BUCKETS // 2
    ret = jnp.where(rel > 0, half, 0)
    n = jnp.abs(rel)
    max_exact = half // 2
    nf = jnp.maximum(n, 1).astype(jnp.float32)
    large = max_exact + (jnp.log(nf / max_exact) / math.log(MAX_DISTANCE / max_exact)
                         * (half - max_exact)).astype(jnp.int32)
    large = jnp.minimum(large, half - 1)
    return ret + jnp.where(n < max_exact, n, large)


def rel_bias(table, qpos, kpos):
    b = t5_bucket(kpos[None, :] - qpos[:, None])
    bias = jnp.transpose(table[b].astype(jnp.float32), (2, 0, 1))
    return bias.reshape(N_KV_HEADS, GROUP, qpos.shape[0], kpos.shape[0])


def split_proj(z):
    offs = np.cumsum([CONV_WIDTH, CONV_WIDTH, CONV_WIDTH, ATTN_WIDTH, KV_WIDTH]).tolist()
    return jnp.split(z, offs, axis=-1)


def causal_conv(gp, conv_w):
    L = gp.shape[1] - (CONV_K - 1)
    out = conv_w[0] * gp[:, 0:L]
    for i in range(1, CONV_K):
        out = out + conv_w[i] * gp[:, i:i + L]
    return out


def sink_attention(q, k, v, bias, key_valid, sinks):
    s = jnp.einsum('bnqkgd,bnskd->bnkgqs', q, k).astype(jnp.float32) * (HEAD_DIM ** -0.5)
    s = s + bias[None, None]
    s = jnp.where(key_valid[None, :, None, None, None, :], s, NEG)
    sink = sinks.astype(jnp.float32).reshape(N_KV_HEADS, GROUP)[None, None, :, :, None, None]
    m = jnp.maximum(jnp.max(s, axis=-1, keepdims=True), sink)
    p = jnp.exp(s - m)
    p = p / (jnp.sum(p, axis=-1, keepdims=True) + jnp.exp(sink - m))
    return jnp.einsum('bnkgqs,bnskd->bnqkgd', p.astype(v.dtype), v)


def mix_prompt(h, w_in, conv_w, sinks, rel_table):
    b, L, _ = h.shape
    cb, cc, cu, q, k, v = split_proj(h @ w_in)
    g = cc * cu
    gp = jnp.pad(g, ((0, 0), (CONV_K - 1, 0), (0, 0)))
    conv_out = cb * causal_conv(gp, conv_w)
    nc = L // CHUNK
    pad = WINDOW_CHUNKS * CHUNK
    q = q.reshape(b, nc, CHUNK, N_KV_HEADS, GROUP, HEAD_DIM)
    k = k.reshape(b, L, N_KV_HEADS, HEAD_DIM)
    v = v.reshape(b, L, N_KV_HEADS, HEAD_DIM)
    kc = jnp.pad(k, ((0, 0), (pad, 0), (0, 0), (0, 0))).reshape(b, nc + WINDOW_CHUNKS, CHUNK, N_KV_HEADS, HEAD_DIM)
    vc = jnp.pad(v, ((0, 0), (pad, 0), (0, 0), (0, 0))).reshape(b, nc + WINDOW_CHUNKS, CHUNK, N_KV_HEADS, HEAD_DIM)
    kb = jnp.concatenate([kc[:, i:i + nc] for i in range(WINDOW_CHUNKS + 1)], axis=2)
    vb = jnp.concatenate([vc[:, i:i + nc] for i in range(WINDOW_CHUNKS + 1)], axis=2)
    qpos = jnp.arange(CHUNK)
    kpos = jnp.arange(BAND) - pad
    bias = rel_bias(rel_table, qpos, kpos)
    valid = (jnp.arange(nc)[:, None] * CHUNK + kpos[None, :]) >= 0
    o = sink_attention(q, kb, vb, bias, valid, sinks)
    attn_out = o.reshape(b, L, ATTN_WIDTH)
    mixed = jnp.concatenate([conv_out, attn_out], axis=-1)
    return mixed, g[:, L - (CONV_K - 1):], k[:, L - WINDOW:], v[:, L - WINDOW:]


def mix_sample(h, conv_state, k_cache, v_cache, w_in, conv_w, sinks, rel_table):
    b, L, _ = h.shape
    cb, cc, cu, q, k, v = split_proj(h @ w_in)
    g = cc * cu
    gp = jnp.concatenate([conv_state.astype(g.dtype), g], axis=1)
    conv_out = cb * causal_conv(gp, conv_w)
    lc = k_cache.shape[1]
    k = k.reshape(b, L, N_KV_HEADS, HEAD_DIM)
    v = v.reshape(b, L, N_KV_HEADS, HEAD_DIM)
    kf = jnp.concatenate([k_cache.astype(k.dtype), k], axis=1)
    vf = jnp.concatenate([v_cache.astype(v.dtype), v], axis=1)
    qpos = PAST_LEN + jnp.arange(L)
    kpos = PAST_LEN - lc + jnp.arange(lc + L)
    bias = rel_bias(rel_table, qpos, kpos)
    valid = (kpos >= 0)[None, :]
    o = sink_attention(q.reshape(b, 1, L, N_KV_HEADS, GROUP, HEAD_DIM), kf[:, None], vf[:, None],
                       bias, valid, sinks)
    attn_out = o.reshape(b, L, ATTN_WIDTH)
    mixed = jnp.concatenate([conv_out, attn_out], axis=-1)
    n_all = lc + L
    return mixed, gp[:, L:], kf[:, n_all - lc:], vf[:, n_all - lc:]


def ffn(x, w_gate, w_up, w_down):
    return (jax.nn.silu(x @ w_gate) * (x @ w_up)) @ w_down


def setup_inputs(seed: int = 0) -> dict:
    key = jax.random.key(seed)
    ks = jax.random.split(key, 20)
    f32 = jnp.float32
    lc = min(WINDOW, PAST_LEN)

    def nrm(k, shape, scale):
        return jax.random.normal(k, shape, f32) * scale

    def gain(k):
        return 1.0 + 0.05 * jax.random.normal(k, (DEPTH, D_MODEL), f32)

    return {
        "x_prompt": nrm(ks[0], (BATCH, SEQ, D_MODEL), 1.0),
        "x_sample": nrm(ks[1], (DEC_BATCH, DEC_SEQ, D_MODEL), 1.0),
        "state_conv": nrm(ks[2], (DEPTH, DEC_BATCH, CONV_K - 1, CONV_WIDTH), 1.0),
        "cache_k": nrm(ks[3], (DEPTH, DEC_BATCH, lc, N_KV_HEADS, HEAD_DIM), 1.0),
        "cache_v": nrm(ks[4], (DEPTH, DEC_BATCH, lc, N_KV_HEADS, HEAD_DIM), 1.0),
        "rel_table": nrm(ks[5], (NUM_BUCKETS, N_HEADS), 0.5),
        "g_pre_mix": gain(ks[6]),
        "w_in": nrm(ks[7], (DEPTH, D_MODEL, IN_COLS), D_MODEL ** -0.5),
        "conv_w": nrm(ks[8], (DEPTH, CONV_K, CONV_WIDTH), CONV_K ** -0.5),
        "attn_sinks": nrm(ks[9], (DEPTH, N_HEADS), 0.5),
        "w_out": nrm(ks[10], (DEPTH, MIX_WIDTH, D_MODEL), MIX_WIDTH ** -0.5),
        "g_post_mix": gain(ks[11]),
        "g_pre_ffn": gain(ks[12]),
        "w_gate": nrm(ks[13], (DEPTH, D_MODEL, D_FF), D_MODEL ** -0.5),
        "w_up": nrm(ks[14], (DEPTH, D_MODEL, D_FF), D_MODEL ** -0.5),
        "w_down": nrm(ks[15], (DEPTH, D_FF, D_MODEL), D_FF ** -0.5),
        "g_post_ffn": gain(ks[16]),
    }


def reference(x_prompt, x_sample, state_conv, cache_k, cache_v, rel_table, g_pre_mix, w_in,
              conv_w, attn_sinks, w_out, g_post_mix, g_pre_ffn, w_gate, w_up, w_down, g_post_ffn):
    yp, ys = x_prompt, x_sample
    pc, pk, pv, sc, sk, sv = [], [], [], [], [], []
    for l in range(DEPTH):
        m, c_new, k_new, v_new = mix_prompt(rmsnorm(yp, g_pre_mix[l]), w_in[l], conv_w[l],
                                            attn_sinks[l], rel_table)
        yp = yp + rmsnorm(m @ w_out[l], g_post_mix[l])
        yp = yp + rmsnorm(ffn(rmsnorm(yp, g_pre_ffn[l]), w_gate[l], w_up[l], w_down[l]), g_post_ffn[l])
        pc.append(c_new); pk.append(k_new); pv.append(v_new)
        m, c_new, k_new, v_new = mix_sample(rmsnorm(ys, g_pre_mix[l]), state_conv[l], cache_k[l],
                                            cache_v[l], w_in[l], conv_w[l], attn_sinks[l], rel_table)
        ys = ys + rmsnorm(m @ w_out[l], g_post_mix[l])
        ys = ys + rmsnorm(ffn(rmsnorm(ys, g_pre_ffn[l]), w_gate[l], w_up[l], w_down[l]), g_post_ffn[l])
        sc.append(c_new); sk.append(k_new); sv.append(v_new)
    new_conv_prompt = jnp.stack(pc)
    new_k_prompt = jnp.stack(pk)
    new_v_prompt = jnp.stack(pv)
    new_conv_sample = jnp.stack(sc)
    new_k_sample = jnp.stack(sk)
    new_v_sample = jnp.stack(sv)
    return (yp, ys, new_conv_prompt, new_k_prompt, new_v_prompt, new_conv_sample, new_k_sample, new_v_sample)
```

```cpp
#include <hip/hip_runtime.h>
#include <cstdio>
#include <cstdint>
#define MK_N_LAUNCHES 8
namespace pg8 {
#define PG8_LAS __attribute__((address_space(3)))
typedef unsigned short bf16_t;
typedef short bf16x8 __attribute__((ext_vector_type(8)));
typedef float f32x4 __attribute__((ext_vector_type(4)));
typedef unsigned u32x4 __attribute__((ext_vector_type(4)));
constexpr int BM = 256, BK = 64, HALF = 128, HTB = HALF * BK * 2  , STAGE_BYTES = 8 * HTB, NXCD = 8, WGM = 8;

__host__ __device__ __forceinline__ int lds_byte(int r, int c) { const int st = (r >> 4) * 2 + (c >> 5), rr = r & 15, cc = c & 31, ob = rr * 64 + cc * 2; return st * 1024 + (ob ^ (((ob >> 9) & 1) << 5)); }
__host__ __device__ __forceinline__ void stage_rc(int b, int& R, int& C) { const int st = b / 1024, sb = b % 1024, swz = sb ^ (((sb >> 9) & 1) << 5); R = (st >> 1) * 16 + swz / 64; C = (st & 1) * 32 + (swz % 64) / 2; }
__host__ __device__ __forceinline__ int perm32(int rho) { const int n = rho >> 4, i = rho & 15; return 8 * (i >> 2) + 4 * n + (i & 3); }

struct Unit { int pm, pn; };
struct Gemm { const bf16_t* A; const bf16_t* Bt; int M, N, K; };

struct StaticOrder {
    int nM, nN, nwg, G, c;
    __host__ __device__ void init(int M, int N, int G_, int c_) { nM = M / BM; nN = N / BM; nwg = nM * nN; G = G_; c = c_; }
    __host__ __device__ bool next(int i, Unit& u) const {
        const long L = (long)i * G + c; if (L >= nwg) return false;
        int wgid = (int)L; { const int q = nwg / NXCD, r = nwg % NXCD, xcd = wgid % NXCD, off = wgid / NXCD; wgid = (xcd < r ? xcd * (q + 1) : r * (q + 1) + (xcd - r) * q) + off; }
        const int nig = WGM * nN, gid = wgid / nig, fm = gid * WGM, gsz = (nM - fm) < WGM ? (nM - fm) : WGM;
        u.pm = fm + ((wgid % nig) % gsz); u.pn = (wgid % nig) / gsz; return true;
    }
    __device__ __forceinline__ void a_ready(const Unit&) const {}
    __device__ __forceinline__ void done(const Unit&) const {}
};

__device__ __forceinline__ unsigned cvt_pk_bf16(float lo, float hi) { unsigned r; asm volatile("v_cvt_pk_bf16_f32 %0, %1, %2" : "=v"(r) : "v"(lo), "v"(hi)); return r; }
typedef float f32x2 __attribute__((ext_vector_type(2)));
__device__ __forceinline__ f32x2 gelu_pk(f32x2 v) {
    const f32x2 av = __builtin_elementwise_abs(v), d = av * 0.2316418882f + 1.0f;
    f32x2 t; t.x = __builtin_amdgcn_rcpf(d.x); t.y = __builtin_amdgcn_rcpf(d.y);
    f32x2 q = t * 0.5307027145f + (-0.7265760135f); q = q * t + 0.7107068705f; q = q * t + (-0.142248368f); q = q * t + 0.127414796f; q = q * t;
    const f32x2 s = (v * v) * (-0.72134752044f);
    f32x2 e; e.x = __builtin_amdgcn_exp2f(s.x); e.y = __builtin_amdgcn_exp2f(s.y);
    const f32x2 m = v * (q * e), r = v - m;
    f32x2 o; o.x = v.x < 0.f ? m.x : r.x; o.y = v.y < 0.f ? m.y : r.y; return o;
}

template <int ACT  > struct EpiBf16 {
    static constexpr bool PERM = true, AFTER_DRAIN = false; static_assert(ACT == 0 || ACT == 1, "EpiBf16: ACT is 0 (none) or 1 (gelu_pk)");
    bf16_t* O; int ldc; const float* bias; int split_cols; size_t split_stride; float scale0;
    __device__ __forceinline__ void operator()(const f32x4 (&acc)[2][2][4][2], const Unit& u, int wr, int wc, int fr, int fq) const {
        const int row0 = u.pm * BM + wr * 64 + fr; int colt = u.pn * BM; bf16_t* base = O;
        float sc = 1.f; if (split_cols) { const int t = colt / split_cols; base += (size_t)t * split_stride; colt -= t * split_cols; if (t == 0) sc = scale0; }
        const int col0 = colt + wc * 32 + 8 * fq, bcol0 = u.pn * BM + wc * 32 + 8 * fq;
        f32x4 bv[2][2];
#pragma unroll
        for (int bj = 0; bj < 2; ++bj)
#pragma unroll
            for (int n = 0; n < 2; ++n) bv[bj][n] = bias ? *(const f32x4*)(bias + bcol0 + bj * HALF + 4 * n) : (f32x4){0.f, 0.f, 0.f, 0.f};
#pragma unroll
        for (int ai = 0; ai < 2; ++ai)
#pragma unroll
            for (int m = 0; m < 4; ++m) { bf16_t* rowp = base + (size_t)(row0 + ai * HALF + m * 16) * ldc + col0;
#pragma unroll
                for (int bj = 0; bj < 2; ++bj) { f32x4 v0 = acc[ai][bj][m][0] + bv[bj][0], v1 = acc[ai][bj][m][1] + bv[bj][1];
                    if (ACT == 1) { f32x2 a = gelu_pk((f32x2){v0[0], v0[1]}), b = gelu_pk((f32x2){v0[2], v0[3]}), c = gelu_pk((f32x2){v1[0], v1[1]}), d = gelu_pk((f32x2){v1[2], v1[3]});
                        v0 = (f32x4){a.x, a.y, b.x, b.y}; v1 = (f32x4){c.x, c.y, d.x, d.y}; }
                    v0 = v0 * sc; v1 = v1 * sc; u32x4 w; w.x = cvt_pk_bf16(v0[0], v0[1]); w.y = cvt_pk_bf16(v0[2], v0[3]); w.z = cvt_pk_bf16(v1[0], v1[1]); w.w = cvt_pk_bf16(v1[2], v1[3]);
                    *(u32x4*)(rowp + bj * HALF) = w; } }
    }
};
struct EpiF32P {
    static constexpr bool PERM = true, AFTER_DRAIN = false;
    float* C; int ldc;
    __device__ __forceinline__ void operator()(const f32x4 (&acc)[2][2][4][2], const Unit& u, int wr, int wc, int fr, int fq) const {
        const int row0 = u.pm * BM + wr * 64 + fr, col0 = u.pn * BM + wc * 32 + 8 * fq;
#pragma unroll
        for (int ai = 0; ai < 2; ++ai)
#pragma unroll
            for (int m = 0; m < 4; ++m) { float* rowp = C + (size_t)(row0 + ai * HALF + m * 16) * ldc + col0;
#pragma unroll
                for (int bj = 0; bj < 2; ++bj) { *(f32x4*)(rowp + bj * HALF) = acc[ai][bj][m][0]; *(f32x4*)(rowp + bj * HALF + 4) = acc[ai][bj][m][1]; } }
    }
};
struct EpiSwiglu {
    static constexpr bool PERM = true, AFTER_DRAIN = false;
    bf16_t* O; int ldc;
    __device__ __forceinline__ void operator()(const f32x4 (&acc)[2][2][4][2], const Unit& u, int wr, int wc, int fr, int fq) const {
        const int row0 = u.pm * BM + wr * 64 + fr, col0 = u.pn * HALF + wc * 32 + 8 * fq;
#pragma unroll
        for (int ai = 0; ai < 2; ++ai)
#pragma unroll
            for (int m = 0; m < 4; ++m) { bf16_t* rowp = O + (size_t)(row0 + ai * HALF + m * 16) * ldc + col0;
                float hv[8];
#pragma unroll
                for (int n = 0; n < 2; ++n)
#pragma unroll
                    for (int e = 0; e < 4; ++e) { const float g = acc[ai][0][m][n][e], up = acc[ai][1][m][n][e];
                        const float sg = g * __builtin_amdgcn_rcpf(1.0f + __builtin_amdgcn_exp2f(-1.4426950408889634f * g)); hv[n * 4 + e] = sg * up; }
                u32x4 w; w.x = cvt_pk_bf16(hv[0], hv[1]); w.y = cvt_pk_bf16(hv[2], hv[3]); w.z = cvt_pk_bf16(hv[4], hv[5]); w.w = cvt_pk_bf16(hv[6], hv[7]);
                *(u32x4*)rowp = w; }
    }
};

template <class Epi, class Sched, bool ALIGN_EPI = false, bool SP2 = false>
__device__ __forceinline__ void gemm_phase(PG8_LAS unsigned char* lds, const Gemm g, const Sched& S, const Epi& E) {
    const int tid = threadIdx.x, wid = __builtin_amdgcn_readfirstlane(tid >> 6), lane = tid & 63, wr = wid >> 2, wc = wid & 3, fr = lane & 15, fq = lane >> 4;
    const int K = g.K, nt = K / BK;
    unsigned voffA[2], voffB[2];
#pragma unroll
    for (int i = 0; i < 2; ++i) { int R, C; stage_rc(tid * 16 + i * 8192, R, C); const int Rb = Epi::PERM ? ((R & ~31) + perm32(R & 31)) : R;
        voffA[i] = (unsigned)(R * K + C) * 2u; voffB[i] = (unsigned)(Rb * K + C) * 2u; }
    const size_t kstep = (size_t)(BK * 2);
    const size_t hstep = (size_t)HALF * K * 2;
    const size_t tstep = 2 * hstep;
    const unsigned ldsw = (unsigned)wid * 1024u;
    const int aoff = lds_byte(wr * 64 + fr, fq * 8), boff = lds_byte(wc * 32 + fr, fq * 8);
#define PG8_SA(b, h) (((b) * 2 + (h)) * HTB)
#define PG8_SB(b, h) ((4 + (b) * 2 + (h)) * HTB)
#define PG8_STAGE(bufoff, gbase, voff) do { _Pragma("unroll") for (int _i = 0; _i < 2; ++_i) \
        __builtin_amdgcn_global_load_lds((const unsigned*)((const char*)(gbase) + (voff)[_i]), (PG8_LAS unsigned*)(lds + (bufoff) + ldsw + _i * 8192), 16, 0, 0); } while (0)
#define PG8_LDA(dst, b, h) do { _Pragma("unroll") for (int m = 0; m < 4; ++m) _Pragma("unroll") for (int k = 0; k < 2; ++k) dst[m][k] = *(const PG8_LAS bf16x8*)(lds + PG8_SA(b, h) + aoff + m * 2048 + k * 1024); } while (0)
#define PG8_LDB(dst, b, h) do { _Pragma("unroll") for (int n = 0; n < 2; ++n) _Pragma("unroll") for (int k = 0; k < 2; ++k) dst[n][k] = *(const PG8_LAS bf16x8*)(lds + PG8_SB(b, h) + boff + n * 2048 + k * 1024); } while (0)
#define PG8_MMA(ai, bj, At, Bt) do { __builtin_amdgcn_s_setprio(1); _Pragma("unroll") for (int m = 0; m < 4; ++m) _Pragma("unroll") for (int n = 0; n < 2; ++n) _Pragma("unroll") for (int k = 0; k < 2; ++k) \
        acc[ai][bj][m][n] = __builtin_amdgcn_mfma_f32_16x16x32_bf16(Bt[n][k], At[m][k], acc[ai][bj][m][n], 0, 0, 0); __builtin_amdgcn_s_setprio(0); } while (0)
#define PG8_WAIT_V(n) asm volatile("s_waitcnt vmcnt(" #n ")" ::: "memory")
#define PG8_WAIT_L(n) asm volatile("s_waitcnt lgkmcnt(" #n ")" ::: "memory")
#define PG8_BAR __builtin_amdgcn_s_barrier()
#define PG8_SCHED __builtin_amdgcn_sched_barrier(0)
    Unit cur, nxt; int ui = 0;
    if (!S.next(0, cur)) return;
    f32x4 acc[2][2][4][2];
#pragma unroll
    for (int a = 0; a < 2; ++a)
#pragma unroll
        for (int b = 0; b < 2; ++b)
#pragma unroll
            for (int m = 0; m < 4; ++m)
#pragma unroll
                for (int n = 0; n < 2; ++n) acc[a][b][m][n] = (f32x4){0.f, 0.f, 0.f, 0.f};
    bf16x8 At[4][2], B0[2][2], B1[2][2];
    const char* cA = (const char*)g.A + (size_t)cur.pm * tstep; const char* cB = (const char*)g.Bt + (size_t)cur.pn * tstep;
    S.a_ready(cur);
    if constexpr (SP2) {
        PG8_STAGE(PG8_SB(0, 0), cB, voffB); PG8_STAGE(PG8_SB(0, 1), cB + hstep, voffB); PG8_STAGE(PG8_SA(0, 0), cA, voffA); PG8_STAGE(PG8_SA(0, 1), cA + hstep, voffA);
        if (wr == 1) PG8_BAR;
        PG8_WAIT_V(2); PG8_BAR;
        PG8_STAGE(PG8_SB(1, 0), cB + kstep, voffB); PG8_STAGE(PG8_SA(1, 0), cA + kstep, voffA); PG8_STAGE(PG8_SB(1, 1), cB + hstep + kstep, voffB);
        PG8_WAIT_V(6); PG8_BAR;
    } else {
        PG8_STAGE(PG8_SB(0, 0), cB, voffB); PG8_STAGE(PG8_SA(0, 0), cA, voffA); PG8_STAGE(PG8_SB(0, 1), cB + hstep, voffB); PG8_STAGE(PG8_SA(0, 1), cA + hstep, voffA);
        if (wr == 1) PG8_BAR;
        PG8_WAIT_V(4); PG8_BAR;
        PG8_STAGE(PG8_SB(1, 0), cB + kstep, voffB); PG8_STAGE(PG8_SA(1, 0), cA + kstep, voffA); PG8_STAGE(PG8_SB(1, 1), cB + hstep + kstep, voffB);
        PG8_WAIT_V(6); PG8_BAR;
    }
    for (;;) {
        const bool has_next = S.next(ui + 1, nxt);
        const char* nA = has_next ? (const char*)g.A + (size_t)nxt.pm * tstep : cA; const char* nB = has_next ? (const char*)g.Bt + (size_t)nxt.pn * tstep : cB;
        for (int t = 0; t < nt; t += 2) {
            const bool last = (t == nt - 2);
            const char* a1 = cA + (size_t)(t + 1) * kstep;
            const char* a2 = last ? nA : cA + (size_t)(t + 2) * kstep; const char* b2 = last ? nB : cB + (size_t)(t + 2) * kstep;
            const char* a3 = a2 + kstep; const char* b3 = b2 + kstep;
            if (last && has_next) S.a_ready(nxt);
            if constexpr (SP2) {
            PG8_LDB(B0, 0, 0); PG8_LDB(B1, 0, 1); PG8_SCHED; PG8_LDA(At, 0, 0); PG8_STAGE(PG8_SA(1, 1), a1 + hstep, voffA);
            PG8_WAIT_V(8); PG8_WAIT_L(0); PG8_BAR; PG8_MMA(0, 0, At, B0); PG8_MMA(0, 1, At, B1); PG8_BAR; PG8_SCHED;
            PG8_LDA(At, 0, 1); PG8_STAGE(PG8_SB(0, 0), b2, voffB); PG8_STAGE(PG8_SB(0, 1), b2 + hstep, voffB); PG8_STAGE(PG8_SA(0, 0), a2, voffA);
            PG8_WAIT_V(8); PG8_WAIT_L(0); PG8_BAR; PG8_MMA(1, 0, At, B0); PG8_MMA(1, 1, At, B1); PG8_BAR; PG8_SCHED;
            PG8_LDB(B0, 1, 0); PG8_LDB(B1, 1, 1); PG8_SCHED; PG8_LDA(At, 1, 0); PG8_STAGE(PG8_SA(0, 1), a2 + hstep, voffA);
            PG8_WAIT_V(8); PG8_WAIT_L(0); PG8_BAR; PG8_MMA(0, 0, At, B0); PG8_MMA(0, 1, At, B1); PG8_BAR; PG8_SCHED;
            PG8_LDA(At, 1, 1); PG8_STAGE(PG8_SB(1, 0), b3, voffB); PG8_STAGE(PG8_SB(1, 1), b3 + hstep, voffB); PG8_STAGE(PG8_SA(1, 0), a3, voffA);
            PG8_WAIT_V(8); PG8_WAIT_L(0); PG8_BAR; PG8_MMA(1, 0, At, B0); PG8_MMA(1, 1, At, B1); PG8_BAR; PG8_SCHED;
            } else {
            PG8_LDB(B0, 0, 0); PG8_SCHED; PG8_LDA(At, 0, 0); PG8_STAGE(PG8_SA(1, 1), a1 + hstep, voffA);
            PG8_WAIT_L(8); PG8_BAR; PG8_WAIT_L(0); PG8_MMA(0, 0, At, B0); PG8_BAR; PG8_SCHED;
            PG8_LDB(B1, 0, 1); PG8_STAGE(PG8_SB(0, 0), b2, voffB);
            PG8_BAR; PG8_WAIT_L(0); PG8_MMA(0, 1, At, B1); PG8_BAR;
            PG8_LDA(At, 0, 1); PG8_STAGE(PG8_SA(0, 0), a2, voffA);
            PG8_BAR; PG8_WAIT_L(0); PG8_MMA(1, 0, At, B0); PG8_BAR; PG8_SCHED;
            PG8_STAGE(PG8_SB(0, 1), b2 + hstep, voffB);
            PG8_WAIT_V(6); PG8_BAR; PG8_MMA(1, 1, At, B1); PG8_BAR;
            PG8_LDB(B0, 1, 0); PG8_SCHED; PG8_LDA(At, 1, 0); PG8_STAGE(PG8_SA(0, 1), a2 + hstep, voffA);
            PG8_WAIT_L(8); PG8_BAR; PG8_WAIT_L(0); PG8_MMA(0, 0, At, B0); PG8_BAR; PG8_SCHED;
            PG8_LDB(B1, 1, 1); PG8_STAGE(PG8_SB(1, 0), b3, voffB);
            PG8_BAR; PG8_WAIT_L(0); PG8_MMA(0, 1, At, B1); PG8_BAR;
            PG8_LDA(At, 1, 1); PG8_STAGE(PG8_SA(1, 0), a3, voffA);
            PG8_BAR; PG8_WAIT_L(0); PG8_MMA(1, 0, At, B0); PG8_BAR; PG8_SCHED;
            PG8_STAGE(PG8_SB(1, 1), b3 + hstep, voffB);
            PG8_WAIT_V(6); PG8_BAR; PG8_MMA(1, 1, At, B1); PG8_BAR;
            }
        }
        if constexpr (ALIGN_EPI) { if (wr == 0) PG8_BAR; }
        if constexpr (!Epi::AFTER_DRAIN) { E(acc, cur, wr, wc, fr, fq); S.done(cur); }
        if (!has_next) break;
#pragma unroll
        for (int a = 0; a < 2; ++a)
#pragma unroll
            for (int b = 0; b < 2; ++b)
#pragma unroll
                for (int m = 0; m < 4; ++m)
#pragma unroll
                    for (int n = 0; n < 2; ++n) acc[a][b][m][n] = (f32x4){0.f, 0.f, 0.f, 0.f};
        cur = nxt; cA = nA; cB = nB; ++ui;
        if constexpr (ALIGN_EPI) { if (wr == 1) PG8_BAR; }
    }
    PG8_WAIT_V(0);
    if constexpr (!ALIGN_EPI) { if (wr == 0) PG8_BAR; }
    PG8_BAR;
    if constexpr (Epi::AFTER_DRAIN) { E.fused(acc, cur, wr, wc, fr, fq, lds, wid, lane); S.done(cur); }
#undef PG8_SA
#undef PG8_SB
#undef PG8_STAGE
#undef PG8_LDA
#undef PG8_LDB
#undef PG8_MMA
#undef PG8_WAIT_V
#undef PG8_WAIT_L
#undef PG8_BAR
#undef PG8_SCHED
}
}

#ifndef PG8_SP2
#define PG8_SP2 true
#endif
#ifndef PG8_ALIGN
#define PG8_ALIGN true
#endif
#define GAS __attribute__((address_space(1)))
#define LAS __attribute__((address_space(3)))
typedef unsigned short bf16;
typedef unsigned v4u __attribute__((ext_vector_type(4)));
typedef float f32x4 __attribute__((ext_vector_type(4)));
typedef short bf16x8 __attribute__((ext_vector_type(8)));
typedef GAS unsigned gu32;
typedef GAS unsigned long long gu64;
#define RLX_AGENT __ATOMIC_RELAXED, __HIP_MEMORY_SCOPE_AGENT
#define LDS_WAIT() asm volatile("s_waitcnt lgkmcnt(0)" ::: "memory")
#define VM_WAIT() asm volatile("s_waitcnt vmcnt(0)" ::: "memory")
__device__ __forceinline__ unsigned long long rt() { return __builtin_amdgcn_s_memrealtime(); }
__device__ __forceinline__ unsigned f2bf(float f) { unsigned u = __builtin_bit_cast(unsigned, f); return (u + 0x7fffu + ((u >> 16) & 1u)) >> 16; }
__device__ __forceinline__ unsigned pk2(float lo, float hi) { return f2bf(lo) | (f2bf(hi) << 16); }

#define XB_TMO      128
#define XB_XCNT(j)  (256  + 64 * (j))
#define XB_XSUB(j)  (1280 + 64 * (j))
#define XB_XGEN(j)  (2304 + 64 * (j))
#define XB_TOP      3328
#define XB_TOPGEN   3392
#define XCD_BAR_WORDS 3456
#define XB_SPIN_CAP (1u << 18)

__device__ __forceinline__ unsigned xb_ld(unsigned* p)              { return __hip_atomic_load(p, __ATOMIC_RELAXED, __HIP_MEMORY_SCOPE_AGENT); }
__device__ __forceinline__ unsigned xb_add(unsigned* p, unsigned v) { return __hip_atomic_fetch_add(p, v, __ATOMIC_RELAXED, __HIP_MEMORY_SCOPE_AGENT); }
__device__ __forceinline__ unsigned xb_xcc_id() { return (unsigned)__builtin_amdgcn_s_getreg((3 << 11) | 20) & 0xFu; }
#define XB_SPIN(cond, bar) do { unsigned _sp = 0; while (cond) { __builtin_amdgcn_s_sleep(1); \
    if ((++_sp & 255u) == 0u) { if (xb_ld(&(bar)[XB_TMO])) break; if (_sp > XB_SPIN_CAP) { atomicAdd(&(bar)[XB_TMO], 1u); break; } } } } while (0)

struct XcdBarrier {
    unsigned* bar; unsigned x;
    volatile LAS unsigned* st;
};

__device__ __forceinline__ XcdBarrier xcd_barrier_post(unsigned* bar, volatile LAS unsigned* st) {
    XcdBarrier b; b.bar = bar; b.x = xb_xcc_id(); b.st = st;
    if (threadIdx.x == 0) (void)xb_add(&bar[XB_XCNT(b.x)], 1u);
    return b;
}
__device__ __forceinline__ void xcd_barrier_complete(unsigned* bar, unsigned x, unsigned& nloc, unsigned& nx) {
    const unsigned G = gridDim.x * gridDim.y * gridDim.z;
    unsigned sum, cnt, mine, sp = 0u;
    for (;;) {
        sum = 0u; cnt = 0u; mine = 0u;
#pragma unroll
        for (unsigned j = 0; j < 16; ++j) { const unsigned c = xb_ld(&bar[XB_XCNT(j)]); sum += c; cnt += (c > 0u) ? 1u : 0u; mine = (j == x) ? c : mine; }
        if (sum == G) break;
        __builtin_amdgcn_s_sleep(1);
        if ((++sp & 255u) == 0u) { if (xb_ld(&bar[XB_TMO])) break; if (sp > XB_SPIN_CAP) { atomicAdd(&bar[XB_TMO], 1u); break; } }
    }
    nloc = mine > 0u ? mine : 1u; nx = cnt > 0u ? cnt : 1u;
}

__device__ __forceinline__ void xcd_barrier(const XcdBarrier& b) {
    asm volatile("s_waitcnt vmcnt(0)" ::: "memory");
    __syncthreads();
    if (threadIdx.x == 0) {
        unsigned* bar = b.bar;
        __builtin_amdgcn_s_waitcnt(0);
        unsigned nloc = b.st[0], nx = b.st[1];
        if (nloc == 0u) { xcd_barrier_complete(bar, b.x, nloc, nx); b.st[0] = nloc; b.st[1] = nx; }
        const unsigned old = xb_add(&bar[XB_XSUB(b.x)], 1u);
        const unsigned gen = old / nloc;
        if (old + 1u == (gen + 1u) * nloc) {
            __builtin_amdgcn_fence(__ATOMIC_RELEASE, "agent");
            asm volatile("s_waitcnt vmcnt(0)" ::: "memory");
            const unsigned og = xb_add(&bar[XB_TOP], 1u);
            const unsigned tg = og / nx;
            if (og + 1u == (tg + 1u) * nx) xb_add(&bar[XB_TOPGEN], 1u);
            else XB_SPIN(xb_ld(&bar[XB_TOPGEN]) == tg, bar);
            __builtin_amdgcn_fence(__ATOMIC_ACQUIRE, "agent");
            xb_add(&bar[XB_XGEN(b.x)], 1u);
            asm volatile("s_waitcnt vmcnt(0)" ::: "memory");
        } else {
            XB_SPIN(xb_ld(&bar[XB_XGEN(b.x)]) == gen, bar);
            __builtin_amdgcn_fence(__ATOMIC_ACQUIRE, "agent");
            asm volatile("s_waitcnt vmcnt(0)" ::: "memory");
        }
    }
    __syncthreads();
}

constexpr int DM = 2048, SEQ = 8192, NB = 2, DB = 16, DSEQ = 64, CHUNK = 64, WINDOW = 128;
constexpr int MP = NB * SEQ, MS = DB * DSEQ, M = MP + MS;
constexpr int CW = 1024, NH = 16, NKV = 4, HD = 64, KVW = NKV * HD;
constexpr int ZP = 3 * CW + NH * HD + 2 * KVW;
constexpr int Z_CB = 0, Z_CC = CW, Z_CU = 2 * CW, Z_Q = 3 * CW, Z_K = 3 * CW + NH * HD, Z_V = Z_K + KVW;
constexpr int FF = 5632;
constexpr float EPS = 1e-6f;
constexpr float LOG2E = 1.4426950408889634f;
constexpr size_t O_Y = 0, O_CP = (size_t)M * DM, O_KP = O_CP + 2 * 2 * CW, O_VP = O_KP + (size_t)NB * WINDOW * KVW, O_CS = O_VP + (size_t)NB * WINDOW * KVW,
                 O_KS = O_CS + (size_t)DB * 2 * CW, O_VS = O_KS + (size_t)DB * WINDOW * KVW, O_END = O_VS + (size_t)DB * WINDOW * KVW;
static_assert(O_END == 36868096, "output size");

namespace att {
typedef short bf16x8 __attribute__((ext_vector_type(8)));
typedef short s16x4 __attribute__((ext_vector_type(4)));
typedef float f32x16 __attribute__((ext_vector_type(16)));
typedef unsigned u32x4 __attribute__((ext_vector_type(4)));
typedef unsigned short bf16_t;
typedef __attribute__((address_space(3))) const char* lds_cptr;
typedef short v4i16_t __attribute__((ext_vector_type(4)));
constexpr int SLOTB = 8192;
constexpr int L_K = 0, L_V = 3 * SLOTB, L_TB = 6 * SLOTB, L_WS = L_TB + 16 * 256 * 4, L_OST = L_WS + 8 * 256, L_END = L_OST + 8 * 4096;
constexpr int NUNITS = NB * (SEQ / CHUNK) * NKV + DB * NKV;
constexpr float NEGBIG = -1e30f;
__device__ __forceinline__ int crow(int r, int hi) { return (r & 3) + 8 * (r >> 2) + 4 * hi; }
__device__ __forceinline__ void glds16(const void* gsrc, unsigned lds_dst) { unsigned keep;
    asm volatile("s_mov_b32 %0, m0\n\ts_mov_b32 m0, %2\n\ts_nop 0\n\tglobal_load_lds_dwordx4 %1, off\n\ts_mov_b32 m0, %0" : "=&s"(keep) : "v"(gsrc), "s"(lds_dst) : "memory"); }
typedef float f32x2_t __attribute__((ext_vector_type(2))); typedef __bf16 bf16x2_t __attribute__((ext_vector_type(2)));
__device__ __forceinline__ unsigned cvtpk_s(float lo, float hi) { f32x2_t v = {lo, hi}; bf16x2_t b = __builtin_convertvector(v, bf16x2_t); return __builtin_bit_cast(unsigned, b); }
__device__ __forceinline__ void pv(f32x16* o, int vb, bf16x8 pa0, bf16x8 pa1, bf16x8 pa2, bf16x8 pa3) {
#pragma unroll
    for (int d0 = 0; d0 < 2; ++d0) { s16x4 lo[4], hi[4];
#pragma unroll
        for (int ks = 0; ks < 4; ++ks) {
            asm volatile("ds_read_b64_tr_b16 %0,%1 offset:%c2" : "=&v"(lo[ks]) : "v"(vb), "i"(d0 * 4096 + ks * 1024) : "memory");
            asm volatile("ds_read_b64_tr_b16 %0,%1 offset:%c2" : "=&v"(hi[ks]) : "v"(vb), "i"(d0 * 4096 + ks * 1024 + 512) : "memory"); }
        asm volatile("s_waitcnt lgkmcnt(0)" ::: "memory"); __builtin_amdgcn_sched_barrier(0);
#define ATT_PK(k) (bf16x8){lo[k][0], lo[k][1], lo[k][2], lo[k][3], hi[k][0], hi[k][1], hi[k][2], hi[k][3]}
        o[d0] = __builtin_amdgcn_mfma_f32_32x32x16_bf16(pa0, ATT_PK(0), o[d0], 0, 0, 0);
        o[d0] = __builtin_amdgcn_mfma_f32_32x32x16_bf16(pa1, ATT_PK(1), o[d0], 0, 0, 0);
        o[d0] = __builtin_amdgcn_mfma_f32_32x32x16_bf16(pa2, ATT_PK(2), o[d0], 0, 0, 0);
        o[d0] = __builtin_amdgcn_mfma_f32_32x32x16_bf16(pa3, ATT_PK(3), o[d0], 0, 0, 0);
#undef ATT_PK
    }
}
__device__ __forceinline__ int t5_bucket(int rel) {
    const int n = rel < 0 ? -rel : rel;
    const int lg = n < 12 ? 8 : n < 16 ? 9 : n < 23 ? 10 : n < 32 ? 11 : n < 46 ? 12 : n < 64 ? 13 : n < 91 ? 14 : 15;
    return (rel > 0 ? 16 : 0) + (n < 8 ? n : lg);
}
__device__ __forceinline__ void build_table(LAS unsigned char* lds, const float* rel_table, int tid) {
    LAS float* tb = (LAS float*)(lds + L_TB);
    for (int i = tid; i < 16 * 256; i += 512) { const int h = i >> 8, idx = i & 255; tb[i] = rel_table[t5_bucket(idx - 191) * NH + h] * LOG2E; }
}
__device__ __forceinline__ void attn_unit(int u, const bf16_t* __restrict__ z, const bf16_t* __restrict__ ck, const bf16_t* __restrict__ cv, bf16_t* __restrict__ mixed, const float* __restrict__ sinks, LAS unsigned char* lds) {
    const int tid = threadIdx.x, lane = tid & 63, r32 = lane & 31, hi = lane >> 5; const int wid = __builtin_amdgcn_readfirstlane(tid >> 6);
    int kh, j0, pit01; long rowq; const bf16_t *kb0, *vb0g;
    if (u < NB * (SEQ / CHUNK) * NKV) { kh = u & 3; const int c = (u >> 2) & 127, b = u >> 9; rowq = (long)b * SEQ + c * CHUNK; j0 = c >= 2 ? 0 : 2 - c; pit01 = ZP;
        kb0 = z + (rowq - 128) * ZP + Z_K + kh * HD; vb0g = z + (rowq - 128) * ZP + Z_V + kh * HD; }
    else { const int us = u - NB * (SEQ / CHUNK) * NKV; kh = us & 3; const int b = us >> 2; rowq = (long)MP + b * DSEQ; j0 = 0; pit01 = KVW;
        kb0 = ck + (long)b * WINDOW * KVW + kh * HD; vb0g = cv + (long)b * WINDOW * KVW + kh * HD; }
    const bf16_t* kb2 = z + rowq * ZP + Z_K + kh * HD; const bf16_t* vb2g = z + rowq * ZP + Z_V + kh * HD;
    const unsigned lds0 = (unsigned)(uintptr_t)lds;
    const long koff = (long)lane * pit01 + wid * 8, voff = (long)(16 * (wid & 3) + (lane >> 2)) * pit01 + (wid >> 2) * 32 + (lane & 3) * 8;
    const unsigned kdst = lds0 + L_K + wid * 1024, vdst = lds0 + L_V + wid * 1024;
    if (j0 <= 0) { glds16(kb0 + koff, (unsigned)__builtin_amdgcn_readfirstlane(kdst)); glds16(vb0g + voff, (unsigned)__builtin_amdgcn_readfirstlane(vdst)); }
    if (j0 <= 1) { glds16(kb0 + (long)64 * pit01 + koff, (unsigned)__builtin_amdgcn_readfirstlane(kdst + SLOTB)); glds16(vb0g + (long)64 * pit01 + voff, (unsigned)__builtin_amdgcn_readfirstlane(vdst + SLOTB)); }
    { const long koff2 = (long)lane * ZP + wid * 8, voff2 = (long)(16 * (wid & 3) + (lane >> 2)) * ZP + (wid >> 2) * 32 + (lane & 3) * 8;
      glds16(kb2 + koff2, (unsigned)__builtin_amdgcn_readfirstlane(kdst + 2 * SLOTB)); glds16(vb2g + voff2, (unsigned)__builtin_amdgcn_readfirstlane(vdst + 2 * SLOTB)); }
    const int hq = kh * 4 + (wid >> 1), qi = (wid & 1) * 32 + r32;
    const bf16_t* Qw = z + (rowq + qi) * ZP + Z_Q + hq * HD + hi * 8;
    bf16x8 qr[4];
#pragma unroll
    for (int d0 = 0; d0 < 4; ++d0) qr[d0] = *reinterpret_cast<const bf16x8*>(Qw + d0 * 16);
    const float sink2 = sinks[hq] * LOG2E;
    asm volatile("s_waitcnt vmcnt(0) lgkmcnt(0)\n\ts_barrier" ::: "memory");
    f32x16 p[6];
    const lds_cptr kp0 = (lds_cptr)lds + L_K + hi * 1024 + r32 * 16;
    const __attribute__((address_space(3))) float* tbp = (const __attribute__((address_space(3))) float*)(lds + L_TB) + (hq * 256 + 63 - qi + 4 * hi);
    constexpr float C2 = 0.125f * LOG2E;
#pragma unroll
    for (int j = 0; j < 3; ++j) {
        if (j >= j0) {
            f32x16 a = f32x16{}, b = f32x16{};
#pragma unroll
            for (int d0 = 0; d0 < 4; ++d0) {
                const bf16x8 k0 = *(const __attribute__((address_space(3))) bf16x8*)(kp0 + j * SLOTB + d0 * 2048);
                const bf16x8 k1 = *(const __attribute__((address_space(3))) bf16x8*)(kp0 + j * SLOTB + d0 * 2048 + 512);
                a = __builtin_amdgcn_mfma_f32_32x32x16_bf16(k0, qr[d0], a, 0, 0, 0); b = __builtin_amdgcn_mfma_f32_32x32x16_bf16(k1, qr[d0], b, 0, 0, 0); }
#pragma unroll
            for (int r = 0; r < 16; ++r) { a[r] = a[r] * C2 + tbp[64 * j + (r & 3) + 8 * (r >> 2)]; b[r] = b[r] * C2 + tbp[64 * j + 32 + (r & 3) + 8 * (r >> 2)]; }
            p[2 * j] = a; p[2 * j + 1] = b;
        } else {
#pragma unroll
            for (int r = 0; r < 16; ++r) { p[2 * j][r] = NEGBIG; p[2 * j + 1][r] = NEGBIG; }
        }
    }
    float mx = sink2;
#pragma unroll
    for (int t = 0; t < 6; ++t)
#pragma unroll
        for (int r = 0; r < 16; ++r) mx = __builtin_fmaxf(mx, p[t][r]);
    { auto rr = __builtin_amdgcn_permlane32_swap(__float_as_uint(mx), __float_as_uint(mx), false, false); mx = __builtin_fmaxf(__uint_as_float(rr[0]), __uint_as_float(rr[1])); }
    float ls = 0.f;
#pragma unroll
    for (int t = 0; t < 6; ++t)
#pragma unroll
        for (int r = 0; r < 16; ++r) { p[t][r] = __builtin_amdgcn_exp2f(p[t][r] - mx); ls += p[t][r]; }
    { auto rr = __builtin_amdgcn_permlane32_swap(__float_as_uint(ls), __float_as_uint(ls), false, false); ls = __uint_as_float(rr[0]) + __uint_as_float(rr[1]); }
    ls += __builtin_amdgcn_exp2f(sink2 - mx);
    f32x16 o[2]; o[0] = f32x16{}; o[1] = f32x16{};
    const int vb0 = (int)(lds0 + L_V) + ((lane >> 4) & 1) * 32 + (lane & 3) * 8 + (4 * hi + ((lane & 15) >> 2)) * 64;
#pragma unroll
    for (int j = 0; j < 3; ++j) {
        if (j >= j0) {
            const f32x16 a = p[2 * j], b = p[2 * j + 1];
            const u32x4 w0 = {cvtpk_s(a[0], a[1]), cvtpk_s(a[2], a[3]), cvtpk_s(a[4], a[5]), cvtpk_s(a[6], a[7])};
            const u32x4 w1 = {cvtpk_s(a[8], a[9]), cvtpk_s(a[10], a[11]), cvtpk_s(a[12], a[13]), cvtpk_s(a[14], a[15])};
            const u32x4 w2 = {cvtpk_s(b[0], b[1]), cvtpk_s(b[2], b[3]), cvtpk_s(b[4], b[5]), cvtpk_s(b[6], b[7])};
            const u32x4 w3 = {cvtpk_s(b[8], b[9]), cvtpk_s(b[10], b[11]), cvtpk_s(b[12], b[13]), cvtpk_s(b[14], b[15])};
            pv(o, vb0 + j * SLOTB, __builtin_bit_cast(bf16x8, w0), __builtin_bit_cast(bf16x8, w1), __builtin_bit_cast(bf16x8, w2), __builtin_bit_cast(bf16x8, w3));
        }
    }
    LAS float* wsf = (LAS float*)(lds + L_WS) + wid * 64;
    if (hi == 0) wsf[r32] = ls;
    asm volatile("s_waitcnt lgkmcnt(0)" ::: "memory");
    float rli[16];
#pragma unroll
    for (int r = 0; r < 16; ++r) rli[r] = __builtin_amdgcn_rcpf(wsf[crow(r, hi)]);
    LAS bf16_t* stg = (LAS bf16_t*)(lds + L_OST) + wid * 2048;
#pragma unroll
    for (int r = 0; r < 16; ++r) { const int orow = crow(r, hi);
#pragma unroll
        for (int d0 = 0; d0 < 2; ++d0) { const unsigned v = cvtpk_s(o[d0][r] * rli[r], 0.f); stg[orow * 64 + d0 * 32 + r32] = (bf16_t)(v & 0xffffu); } }
    asm volatile("s_waitcnt lgkmcnt(0)" ::: "memory");
    bf16_t* Ow = mixed + (rowq + (wid & 1) * 32) * DM + CW + hq * HD;
#pragma unroll
    for (int i = 0; i < 4; ++i) { const int row = i * 8 + (lane >> 3), ch = lane & 7; const u32x4 v = *(const LAS u32x4*)(stg + row * 64 + ch * 8); *(u32x4*)(Ow + (long)row * DM + ch * 8) = v; }
    asm volatile("s_waitcnt lgkmcnt(0)\n\ts_barrier" ::: "memory");
}
}

constexpr int NWAVES = 8;
#ifndef MK_N_LAUNCHES
#define MK_N_LAUNCHES 1
#endif
constexpr int NPHASE = 8;
constexpr int N_LAUNCHES = MK_N_LAUNCHES;
static_assert(N_LAUNCHES == 1 || N_LAUNCHES == NPHASE, "MK_N_LAUNCHES is 1 or 8");

constexpr size_t MiB = 1u << 20;
constexpr size_t WS_CTL = 0, CTL_ZERO_BYTES = 1 * MiB;
constexpr size_t WS_WIN = 2 * MiB;
constexpr size_t WS_WOUT = 20 * MiB;
constexpr size_t WS_WGU = 28 * MiB;
constexpr size_t WS_WDN = 72 * MiB;
constexpr size_t WS_CK = 94 * MiB, WS_CV = 95 * MiB;
constexpr size_t WS_B = 96 * MiB;
constexpr size_t WS_A = 232 * MiB;
constexpr size_t WS_END = 420 * MiB;
static_assert(WS_WIN + (size_t)ZP * DM * 2 <= WS_WOUT && WS_WOUT + (size_t)DM * DM * 2 <= WS_WGU && WS_WGU + (size_t)2 * FF * DM * 2 <= WS_WDN && WS_WDN + (size_t)DM * FF * 2 <= WS_CK, "weight map");
static_assert(WS_B + (size_t)M * DM * 4 <= WS_A && WS_A + (size_t)M * FF * 2 <= WS_END && WS_A + (size_t)M * ZP * 2 <= WS_END, "activation map");
constexpr int CW_TMO = 0, CW_CODE = 1;
constexpr int CW_BAR = 4096;

constexpr int RING_OFF = 0, RING_BYTES = 131072;
constexpr int LDSCTL_OFF = RING_BYTES, MISC_OFF = LDSCTL_OFF + 320;
constexpr int LDS_BYTES = 147456;
static_assert(MISC_OFF + 128 <= LDS_BYTES && att::L_END <= RING_BYTES, "LDS map");

struct Frame {
    LAS unsigned char* lds;
    volatile LAS unsigned* MISC;
    gu32* ctl;
    int tid, lane, wave;
    int vcu, G;
};
__device__ __forceinline__ float wave_sum(float v) {
#pragma unroll
    for (int o = 1; o < 64; o <<= 1) v += __shfl_xor(v, o);
    return v;
}
__device__ __forceinline__ float bf_lo(unsigned w) { return __uint_as_float(w << 16); }
__device__ __forceinline__ float bf_hi(unsigned w) { return __uint_as_float(w & 0xffff0000u); }
__device__ __forceinline__ unsigned pkbf(float lo, float hi) { return att::cvtpk_s(lo, hi); }

template <int MODE> __device__ __forceinline__ void p0_transpose_item(const float* W, int K, int N, bf16* WT, LAS float* scr, int item, int lane) {
    const int nblk = N / 32, kb = item / nblk, nb = item % nblk, k0 = 64 * kb, n0 = 32 * nb;
    const int r0 = MODE == 0 ? n0 : (n0 / 128) * 256 + (n0 % 128) + (MODE == 2 ? 128 : 0);
#pragma unroll 8
    for (int i = 0; i < 32; ++i) { const int kk = 2 * i + (lane >> 5); scr[kk * 33 + (lane & 31)] = W[(size_t)(k0 + kk) * N + n0 + (lane & 31)]; }
    LDS_WAIT(); asm volatile("" ::: "memory");
    const int c = lane & 7;
#pragma unroll
    for (int j = 0; j < 4; ++j) { const int n = (lane >> 3) + 8 * j; const LAS float* s = scr + (8 * c) * 33 + n;
        v4u o; o.x = pkbf(s[0 * 33], s[1 * 33]); o.y = pkbf(s[2 * 33], s[3 * 33]); o.z = pkbf(s[4 * 33], s[5 * 33]); o.w = pkbf(s[6 * 33], s[7 * 33]);
        *(GAS v4u*)(WT + (size_t)(r0 + n) * K + k0 + 8 * c) = o; }
    LDS_WAIT(); asm volatile("" ::: "memory");
}
__device__ __forceinline__ const float* xrow_ptr(const float* xp, const float* xs, int m) { return m < MP ? xp + (size_t)m * DM : xs + (size_t)(m - MP) * DM; }
__device__ __forceinline__ void rms_row_to_bf16(const float* xrow, const float* g, bf16* orow, int lane) {
    const GAS f32x4* xr = (const GAS f32x4*)xrow + lane; const GAS f32x4* gr = (const GAS f32x4*)g + lane;
    f32x4 v[8]; float s = 0.f;
#pragma unroll
    for (int j = 0; j < 8; ++j) { v[j] = xr[64 * j]; s += (v[j].x * v[j].x + v[j].y * v[j].y) + (v[j].z * v[j].z + v[j].w * v[j].w); }
    const float rstd = 1.f / sqrtf(wave_sum(s) * (1.f / DM) + EPS);
    GAS unsigned long long* o8 = (GAS unsigned long long*)orow + lane;
#pragma unroll
    for (int j = 0; j < 8; ++j) { const f32x4 gg = gr[64 * j]; o8[64 * j] = (unsigned long long)pkbf(v[j].x * rstd * gg.x, v[j].y * rstd * gg.y) | ((unsigned long long)pkbf(v[j].z * rstd * gg.z, v[j].w * rstd * gg.w) << 32); }
}

struct Args { const float* in[17]; float* out; unsigned char* ws; int ph_lo, ph_hi; };
static_assert(sizeof(Args) == 17 * 8 + 8 + 8 + 8, "Args has no padding");

__global__ void __launch_bounds__(NWAVES * 64, 2) mega_fwd(Args args) {
    extern __shared__ __attribute__((aligned(16))) unsigned char lds[];
    Frame F;
    F.lds = (LAS unsigned char*)lds;
    F.MISC = (volatile LAS unsigned*)(F.lds + MISC_OFF);
    F.tid = threadIdx.x; F.lane = F.tid & 63; F.wave = __builtin_amdgcn_readfirstlane(F.tid >> 6);
    F.G = gridDim.x; { const int bx = blockIdx.x; F.vcu = (F.G % 8 == 0) ? (bx % 8) * (F.G / 8) + bx / 8 : bx; }
    unsigned char* ws = args.ws;
    F.ctl = (gu32*)(ws + WS_CTL);
    const float* x_p = args.in[0]; const float* x_s = args.in[1]; const float* state_conv = args.in[2]; const float* cache_k = args.in[3]; const float* cache_v = args.in[4];
    const float* rel_table = args.in[5]; const float* g_pre_mix = args.in[6]; const float* w_in = args.in[7]; const float* conv_w = args.in[8]; const float* sinks = args.in[9];
    const float* w_out = args.in[10]; const float* g_post_mix = args.in[11]; const float* g_pre_ffn = args.in[12]; const float* w_gate = args.in[13]; const float* w_up = args.in[14];
    const float* w_down = args.in[15]; const float* g_post_ffn = args.in[16];
    float* out = args.out;
    bf16* Win_t = (bf16*)(ws + WS_WIN); bf16* Wout_t = (bf16*)(ws + WS_WOUT); bf16* Wgu_t = (bf16*)(ws + WS_WGU); bf16* Wdn_t = (bf16*)(ws + WS_WDN);
    bf16* CK = (bf16*)(ws + WS_CK); bf16* CV = (bf16*)(ws + WS_CV);
    bf16* XN = (bf16*)(ws + WS_B); bf16* MIX = (bf16*)(ws + WS_B); bf16* XN2 = (bf16*)(ws + WS_B); float* ACC4 = (float*)(ws + WS_B);
    bf16* Z = (bf16*)(ws + WS_A); float* ACC2 = (float*)(ws + WS_A); bf16* HB = (bf16*)(ws + WS_A);

    for (int u = F.tid; u < (LDS_BYTES - LDSCTL_OFF) / 4; u += NWAVES * 64) ((LAS unsigned*)(F.lds + LDSCTL_OFF))[u] = 0u;
    __syncthreads();
    XcdBarrier bar; bar.bar = (unsigned*)(F.ctl + CW_BAR); bar.x = 0; bar.st = nullptr;
    if (N_LAUNCHES == 1) bar = xcd_barrier_post((unsigned*)(F.ctl + CW_BAR), F.MISC + 8);
#define GRID_BAR() do { if (N_LAUNCHES == 1) xcd_barrier(bar); } while (0)
    const int lo = args.ph_lo, hi = args.ph_hi;
#define IN(k) (lo <= (k) && (k) < hi)
#define BOTH(k) (IN(k) && IN((k) + 1))
    const int gw = F.vcu * NWAVES + F.wave, NGW = F.G * NWAVES;
    const int gt = F.vcu * (NWAVES * 64) + F.tid, NGT = F.G * NWAVES * 64;

    if (IN(0)) {
        LAS float* scr = (LAS float*)(F.lds + RING_OFF + F.wave * 16384);
        constexpr int I_IN = (DM / 64) * (ZP / 32), I_OUT = (DM / 64) * (DM / 32), I_G = (DM / 64) * (FF / 32), I_D = (FF / 64) * (DM / 32);
        constexpr int NITEMS = I_IN + I_OUT + 2 * I_G + I_D;
        for (int it = gw; it < NITEMS; it += NGW) {
            int r = it;
            if (r < I_IN) { p0_transpose_item<0>(w_in, DM, ZP, Win_t, scr, r, F.lane); continue; } r -= I_IN;
            if (r < I_OUT) { p0_transpose_item<0>(w_out, DM, DM, Wout_t, scr, r, F.lane); continue; } r -= I_OUT;
            if (r < I_G) { p0_transpose_item<1>(w_gate, DM, FF, Wgu_t, scr, r, F.lane); continue; } r -= I_G;
            if (r < I_G) { p0_transpose_item<2>(w_up, DM, FF, Wgu_t, scr, r, F.lane); continue; } r -= I_G;
            p0_transpose_item<0>(w_down, FF, DM, Wdn_t, scr, r, F.lane);
        }
        for (int m = gw; m < M; m += NGW) rms_row_to_bf16(xrow_ptr(x_p, x_s, m), g_pre_mix, XN + (size_t)m * DM, F.lane);
        for (int i = gt; i < 2 * DB * WINDOW * KVW / 4; i += NGT) { const int which = i >= DB * WINDOW * KVW / 4; const int j = which ? i - DB * WINDOW * KVW / 4 : i;
            const f32x4 v = ((const GAS f32x4*)(which ? cache_v : cache_k))[j];
            ((GAS unsigned long long*)(which ? CV : CK))[j] = (unsigned long long)pkbf(v.x, v.y) | ((unsigned long long)pkbf(v.z, v.w) << 32); }
        if (BOTH(0)) GRID_BAR();
    }

    if (IN(1)) {
        pg8::Gemm g{XN, Win_t, M, ZP, DM}; pg8::StaticOrder S; S.init(M, ZP, F.G, (int)blockIdx.x);
        pg8::EpiBf16<0> E{Z, ZP, nullptr, 0, 0, 1.f};
        pg8::gemm_phase<pg8::EpiBf16<0>, pg8::StaticOrder, PG8_ALIGN, PG8_SP2>(F.lds + RING_OFF, g, S, E);
        if (BOTH(1)) GRID_BAR();
    }

    if (IN(2)) {
        att::build_table(F.lds + RING_OFF, rel_table, F.tid);
        LDS_WAIT(); __syncthreads();
        for (int u = F.vcu; u < att::NUNITS; u += F.G) att::attn_unit(u, Z, CK, CV, MIX, sinks, F.lds + RING_OFF);
        for (int it = gw; it < (M / 8) * 2; it += NGW) {
            const int m0 = (it >> 1) * 8, ch = (it & 1) * 512 + F.lane * 8;
            const bool smp = m0 >= MP; const int t0 = smp ? ((m0 - MP) & 63) : (m0 & (SEQ - 1)); const int sb = smp ? (m0 - MP) >> 6 : m0 >> 13; const int L = smp ? DSEQ : SEQ;
            float g1[8], g2[8], w0[8], w1[8], w2[8];
            { const f32x4 a = *(const GAS f32x4*)(conv_w + ch), b = *(const GAS f32x4*)(conv_w + ch + 4); w0[0] = a.x; w0[1] = a.y; w0[2] = a.z; w0[3] = a.w; w0[4] = b.x; w0[5] = b.y; w0[6] = b.z; w0[7] = b.w; }
            { const f32x4 a = *(const GAS f32x4*)(conv_w + CW + ch), b = *(const GAS f32x4*)(conv_w + CW + ch + 4); w1[0] = a.x; w1[1] = a.y; w1[2] = a.z; w1[3] = a.w; w1[4] = b.x; w1[5] = b.y; w1[6] = b.z; w1[7] = b.w; }
            { const f32x4 a = *(const GAS f32x4*)(conv_w + 2 * CW + ch), b = *(const GAS f32x4*)(conv_w + 2 * CW + ch + 4); w2[0] = a.x; w2[1] = a.y; w2[2] = a.z; w2[3] = a.w; w2[4] = b.x; w2[5] = b.y; w2[6] = b.z; w2[7] = b.w; }
            if (t0 == 0) {
                if (smp) { const float* st = state_conv + (size_t)sb * 2 * CW + ch;
                    const f32x4 a = *(const GAS f32x4*)(st), b = *(const GAS f32x4*)(st + 4), c = *(const GAS f32x4*)(st + CW), d = *(const GAS f32x4*)(st + CW + 4);
                    g2[0] = a.x; g2[1] = a.y; g2[2] = a.z; g2[3] = a.w; g2[4] = b.x; g2[5] = b.y; g2[6] = b.z; g2[7] = b.w;
                    g1[0] = c.x; g1[1] = c.y; g1[2] = c.z; g1[3] = c.w; g1[4] = d.x; g1[5] = d.y; g1[6] = d.z; g1[7] = d.w; }
                else {
#pragma unroll
                    for (int e = 0; e < 8; ++e) { g1[e] = 0.f; g2[e] = 0.f; } }
            } else {
                const bf16* zr = Z + (size_t)(m0 - 2) * ZP + ch;
                const v4u c2 = *(const GAS v4u*)(zr + Z_CC), u2 = *(const GAS v4u*)(zr + Z_CU), c1 = *(const GAS v4u*)(zr + ZP + Z_CC), u1 = *(const GAS v4u*)(zr + ZP + Z_CU);
#pragma unroll
                for (int e = 0; e < 4; ++e) { g2[2 * e] = bf_lo(c2[e]) * bf_lo(u2[e]); g2[2 * e + 1] = bf_hi(c2[e]) * bf_hi(u2[e]); g1[2 * e] = bf_lo(c1[e]) * bf_lo(u1[e]); g1[2 * e + 1] = bf_hi(c1[e]) * bf_hi(u1[e]); }
            }
#pragma unroll
            for (int r = 0; r < 8; ++r) {
                const bf16* zr = Z + (size_t)(m0 + r) * ZP + ch;
                const v4u vb = *(const GAS v4u*)(zr + Z_CB), vc = *(const GAS v4u*)(zr + Z_CC), vu = *(const GAS v4u*)(zr + Z_CU);
                float g0[8], o[8];
#pragma unroll
                for (int e = 0; e < 4; ++e) { g0[2 * e] = bf_lo(vc[e]) * bf_lo(vu[e]); g0[2 * e + 1] = bf_hi(vc[e]) * bf_hi(vu[e]); }
#pragma unroll
                for (int e = 0; e < 4; ++e) { o[2 * e] = bf_lo(vb[e]) * (w0[2 * e] * g2[2 * e] + w1[2 * e] * g1[2 * e] + w2[2 * e] * g0[2 * e]);
                                              o[2 * e + 1] = bf_hi(vb[e]) * (w0[2 * e + 1] * g2[2 * e + 1] + w1[2 * e + 1] * g1[2 * e + 1] + w2[2 * e + 1] * g0[2 * e + 1]); }
                v4u w; w.x = pkbf(o[0], o[1]); w.y = pkbf(o[2], o[3]); w.z = pkbf(o[4], o[5]); w.w = pkbf(o[6], o[7]);
                *(GAS v4u*)(MIX + (size_t)(m0 + r) * DM + ch) = w;
#pragma unroll
                for (int e = 0; e < 8; ++e) { g2[e] = g1[e]; g1[e] = g0[e]; }
            }
            if (t0 + 8 == L) {
                float* oc = out + (smp ? O_CS : O_CP) + (size_t)sb * 2 * CW + ch;
                *(GAS f32x4*)(oc) = (f32x4){g2[0], g2[1], g2[2], g2[3]}; *(GAS f32x4*)(oc + 4) = (f32x4){g2[4], g2[5], g2[6], g2[7]};
                *(GAS f32x4*)(oc + CW) = (f32x4){g1[0], g1[1], g1[2], g1[3]}; *(GAS f32x4*)(oc + CW + 4) = (f32x4){g1[4], g1[5], g1[6], g1[7]};
            }
        }
        constexpr int NPV = NB * WINDOW * KVW / 4, NSV = DB * WINDOW * KVW / 4;
        for (int i = gt; i < 2 * NPV + 2 * NSV; i += NGT) {
            if (i < 2 * NPV) { const int which = i / NPV, j = i % NPV, b = j >> 13, r = (j >> 6) & 127, c4 = j & 63;
                const unsigned long long w = *(const GAS unsigned long long*)(Z + (size_t)(b * SEQ + SEQ - WINDOW + r) * ZP + (which ? Z_V : Z_K) + c4 * 4);
                const unsigned wl = (unsigned)w, wh = (unsigned)(w >> 32);
                *(GAS f32x4*)(out + (which ? O_VP : O_KP) + (size_t)j * 4) = (f32x4){bf_lo(wl), bf_hi(wl), bf_lo(wh), bf_hi(wh)};
            } else { const int i2 = i - 2 * NPV; const int which = i2 / NSV, j = i2 % NSV, b = j >> 13, r = (j >> 6) & 127, c4 = j & 63;
                f32x4 v;
                if (r < 64) v = *(const GAS f32x4*)((which ? cache_v : cache_k) + (size_t)(b * WINDOW + 64 + r) * KVW + c4 * 4);
                else { const unsigned long long w = *(const GAS unsigned long long*)(Z + (size_t)(MP + b * DSEQ + r - 64) * ZP + (which ? Z_V : Z_K) + c4 * 4);
                    const unsigned wl = (unsigned)w, wh = (unsigned)(w >> 32); v = (f32x4){bf_lo(wl), bf_hi(wl), bf_lo(wh), bf_hi(wh)}; }
                *(GAS f32x4*)(out + (which ? O_VS : O_KS) + (size_t)j * 4) = v;
            }
        }
        if (BOTH(2)) GRID_BAR();
    }

    if (IN(3)) {
        pg8::Gemm g{MIX, Wout_t, M, DM, DM}; pg8::StaticOrder S; S.init(M, DM, F.G, (int)blockIdx.x);
        pg8::EpiF32P E{ACC2, DM};
        pg8::gemm_phase<pg8::EpiF32P, pg8::StaticOrder, PG8_ALIGN, PG8_SP2>(F.lds + RING_OFF, g, S, E);
        if (BOTH(3)) GRID_BAR();
    }

    if (IN(4)) {
        for (int m = gw; m < M; m += NGW) {
            const GAS f32x4* ar = (const GAS f32x4*)(ACC2 + (size_t)m * DM) + F.lane; const GAS f32x4* xr = (const GAS f32x4*)xrow_ptr(x_p, x_s, m) + F.lane;
            const GAS f32x4* g1r = (const GAS f32x4*)g_post_mix + F.lane; const GAS f32x4* g2r = (const GAS f32x4*)g_pre_ffn + F.lane;
            f32x4 a[8], xv[8]; float s = 0.f;
#pragma unroll
            for (int j = 0; j < 8; ++j) { a[j] = ar[64 * j]; xv[j] = xr[64 * j]; s += (a[j].x * a[j].x + a[j].y * a[j].y) + (a[j].z * a[j].z + a[j].w * a[j].w); }
            const float rstd1 = 1.f / sqrtf(wave_sum(s) * (1.f / DM) + EPS); float s2 = 0.f;
            GAS f32x4* orow = (GAS f32x4*)(out + O_Y + (size_t)m * DM) + F.lane;
#pragma unroll
            for (int j = 0; j < 8; ++j) { const f32x4 gg = g1r[64 * j]; xv[j] = xv[j] + a[j] * rstd1 * gg; orow[64 * j] = xv[j]; s2 += (xv[j].x * xv[j].x + xv[j].y * xv[j].y) + (xv[j].z * xv[j].z + xv[j].w * xv[j].w); }
            const float rstd2 = 1.f / sqrtf(wave_sum(s2) * (1.f / DM) + EPS);
            GAS unsigned long long* o8 = (GAS unsigned long long*)(XN2 + (size_t)m * DM) + F.lane;
#pragma unroll
            for (int j = 0; j < 8; ++j) { const f32x4 gg = g2r[64 * j]; o8[64 * j] = (unsigned long long)pkbf(xv[j].x * rstd2 * gg.x, xv[j].y * rstd2 * gg.y) | ((unsigned long long)pkbf(xv[j].z * rstd2 * gg.z, xv[j].w * rstd2 * gg.w) << 32); }
        }
        if (BOTH(4)) GRID_BAR();
    }

    if (IN(5)) {
        pg8::Gemm g{XN2, Wgu_t, M, 2 * FF, DM}; pg8::StaticOrder S; S.init(M, 2 * FF, F.G, (int)blockIdx.x);
        pg8::EpiSwiglu E{HB, FF};
        pg8::gemm_phase<pg8::EpiSwiglu, pg8::StaticOrder, PG8_ALIGN, PG8_SP2>(F.lds + RING_OFF, g, S, E);
        if (BOTH(5)) GRID_BAR();
    }

    if (IN(6)) {
        pg8::Gemm g{HB, Wdn_t, M, DM, FF}; pg8::StaticOrder S; S.init(M, DM, F.G, (int)blockIdx.x);
        pg8::EpiF32P E{ACC4, DM};
        pg8::gemm_phase<pg8::EpiF32P, pg8::StaticOrder, PG8_ALIGN, PG8_SP2>(F.lds + RING_OFF, g, S, E);
        if (BOTH(6)) GRID_BAR();
    }

    if (IN(7)) {
        unsigned poison = (__hip_atomic_load(F.ctl + CW_BAR + XB_TMO, RLX_AGENT) != 0u);
        const float qnan = __builtin_nanf("");
        for (int m = gw; m < M; m += NGW) {
            const GAS f32x4* ar = (const GAS f32x4*)(ACC4 + (size_t)m * DM) + F.lane; GAS f32x4* yr = (GAS f32x4*)(out + O_Y + (size_t)m * DM) + F.lane;
            const GAS f32x4* gr = (const GAS f32x4*)g_post_ffn + F.lane;
            f32x4 a[8], xv[8]; float s = 0.f;
#pragma unroll
            for (int j = 0; j < 8; ++j) { a[j] = ar[64 * j]; xv[j] = yr[64 * j]; s += (a[j].x * a[j].x + a[j].y * a[j].y) + (a[j].z * a[j].z + a[j].w * a[j].w); }
            const float rstd = 1.f / sqrtf(wave_sum(s) * (1.f / DM) + EPS);
#pragma unroll
            for (int j = 0; j < 8; ++j) { const f32x4 gg = gr[64 * j]; f32x4 y = xv[j] + a[j] * rstd * gg; if (poison) y = (f32x4){qnan, qnan, qnan, qnan}; yr[64 * j] = y; }
        }
    }
#undef IN
#undef BOTH
#undef GRID_BAR
}

extern "C" void kernel_launch(void* const* d_in, const int* in_sizes, int n_in, void* d_out, int out_size, void* d_ws, size_t ws_size, hipStream_t stream) {
    static int grid = 0;
    if (grid == 0) {
        if (n_in != 17 || in_sizes[0] != MP * DM || out_size != (int)O_END || ws_size < WS_END) { fprintf(stderr, "kernel_launch: unexpected shapes (n_in %d, in0 %d, out %d, ws %zu); nothing launched\n", n_in, n_in > 0 ? in_sizes[0] : -1, out_size, ws_size); grid = -1; return; }
        int dev = 0, cus = 0, per_cu = 0;
        if (hipGetDevice(&dev) != hipSuccess || hipDeviceGetAttribute(&cus, hipDeviceAttributeMultiprocessorCount, dev) != hipSuccess) { fprintf(stderr, "kernel_launch: device query failed\n"); grid = -1; return; }
        if (hipFuncSetAttribute((const void*)mega_fwd, hipFuncAttributeMaxDynamicSharedMemorySize, LDS_BYTES) != hipSuccess) { fprintf(stderr, "kernel_launch: hipFuncSetAttribute failed\n"); grid = -1; return; }
        if (hipOccupancyMaxActiveBlocksPerMultiprocessor(&per_cu, (const void*)mega_fwd, NWAVES * 64, LDS_BYTES) != hipSuccess || per_cu < 1)
            fprintf(stderr, "kernel_launch: note: occupancy query reports %d workgroups per CU\n", per_cu);
        (void)hipGetLastError();
        grid = cus;
    }
    if (grid < 0) return;
    if (hipMemsetAsync((char*)d_ws + WS_CTL, 0, CTL_ZERO_BYTES, stream) != hipSuccess) { fprintf(stderr, "kernel_launch: hipMemsetAsync failed\n"); return; }
    Args a{};
    for (int i = 0; i < 17; ++i) a.in[i] = (const float*)d_in[i];
    a.out = (float*)d_out; a.ws = (unsigned char*)d_ws;
    for (int li = 0; li < N_LAUNCHES; ++li) {
        a.ph_lo = (N_LAUNCHES == 1) ? 0 : li; a.ph_hi = (N_LAUNCHES == 1) ? NPHASE : li + 1;
        hipLaunchKernelGGL(mega_fwd, dim3(grid), dim3(NWAVES * 64), LDS_BYTES, stream, a);
        const hipError_t le = hipPeekAtLastError();
        if (le != hipSuccess) { fprintf(stderr, "kernel_launch: launch %d failed: %s\n", li, hipGetErrorName(le)); break; }
    }
}
```
